# Optimizing an MI355X kernel written in HIP

```python
import math
import jax, jax.numpy as jnp
from jax import lax
import numpy as np

D_MODEL = 1024
BATCH = 16
SEQ = 2048
DEPTH = 1

W_S5 = D_MODEL // 2
S5_GROUP_CH = 16
S5_GROUPS = W_S5 // S5_GROUP_CH
S5_STATE = 64
W_LRU = D_MODEL - W_S5
LRU_HEADS = 8
LRU_HEAD_DIM = W_LRU // LRU_HEADS
CONV_WIDTH = 4
RG_C = 8.0
D_FF = int(math.ceil(8 * D_MODEL / 3 / 256) * 256)
D_IN = W_S5 + 2 * W_LRU
EPS = 1e-6

kernel_name = "hybrid_s5_rglru_parallel_heads"


def rms_norm(x, g):
    xf = x.astype(jnp.float32)
    ms = jnp.mean(xf * xf, axis=-1, keepdims=True)
    return (xf * lax.rsqrt(ms + EPS) * g.astype(jnp.float32)).astype(x.dtype)


def _linear_combine(p, q):
    a_i, b_i = p
    a_j, b_j = q
    return a_j * a_i, a_j * b_i + b_j


def s5_mixer(u, lam_re, lam_im, log_step, b_re, b_im, c_re, c_im, d, w_glu, b_glu):
    bsz, seq, _ = u.shape
    f32 = jnp.float32
    uf = u.astype(f32).reshape(bsz, seq, S5_GROUPS, S5_GROUP_CH)
    lam = lax.complex(jnp.minimum(lam_re.astype(f32), -1e-4), lam_im.astype(f32))
    step = jnp.exp(log_step.astype(f32))[:, None]
    lam_bar = jnp.exp(lam * step)
    b = lax.complex(b_re.astype(f32), b_im.astype(f32))
    b_bar = ((lam_bar - 1.0) / lam)[..., None] * b
    bu = lax.complex(jnp.einsum('blgc,gnc->blgn', uf, jnp.real(b_bar)),
                     jnp.einsum('blgc,gnc->blgn', uf, jnp.imag(b_bar)))
    lam_elems = jnp.broadcast_to(lam_bar, (seq, S5_GROUPS, S5_STATE))
    states = jax.vmap(lambda e: lax.associative_scan(_linear_combine, (lam_elems, e))[1])(bu)
    y = (jnp.einsum('blgn,gcn->blgc', jnp.real(states), c_re.astype(f32))
         - jnp.einsum('blgn,gcn->blgc', jnp.imag(states), c_im.astype(f32))
         + d.astype(f32) * uf)
    y = y.reshape(bsz, seq, W_S5)
    z = jax.nn.gelu(y)
    z = z * jax.nn.sigmoid(z @ w_glu.astype(f32) + b_glu.astype(f32))
    return z.astype(u.dtype)


def rglru_mixer(xr, yr, conv_w, conv_b, w_a, b_a, w_x, b_x, lam):
    bsz, seq, _ = xr.shape
    f32 = jnp.float32
    xf = xr.astype(f32)
    xpad = jnp.pad(xf, ((0, 0), (CONV_WIDTH - 1, 0), (0, 0)))
    cw = conv_w.astype(f32)
    conv = conv_b.astype(f32) + sum(xpad[:, k:k + seq, :] * cw[k] for k in range(CONV_WIDTH))
    xh = conv.reshape(bsz, seq, LRU_HEADS, LRU_HEAD_DIM)
    r = jax.nn.sigmoid(jnp.einsum('blhi,hij->blhj', xh, w_a.astype(f32)) + b_a.astype(f32))
    i = jax.nn.sigmoid(jnp.einsum('blhi,hij->blhj', xh, w_x.astype(f32)) + b_x.astype(f32))
    log_a = RG_C * r * jax.nn.log_sigmoid(lam.astype(f32))
    a = jnp.exp(log_a)
    gated = jnp.sqrt(-jnp.expm1(2.0 * log_a)) * (i * xh)
    _, h = lax.associative_scan(_linear_combine, (a, gated), axis=1)
    out = h.reshape(bsz, seq, W_LRU) * jax.nn.gelu(yr.astype(f32))
    return out.astype(xr.dtype)


def setup_inputs(seed: int = 0) -> dict:
    key = jax.random.key(seed)
    ks = jax.random.split(key, 32)
    f32 = jnp.float32
    nrm = lambda k, shape, std: std * jax.random.normal(k, shape, f32)
    x = jax.random.normal(ks[0], (BATCH, SEQ, D_MODEL), f32)
    norm1_g = 1.0 + nrm(ks[1], (DEPTH, D_MODEL), 0.02)
    w_in = nrm(ks[2], (DEPTH, D_MODEL, D_IN), D_MODEL ** -0.5)
    n_idx = jnp.arange(S5_STATE, dtype=f32)
    s5_lambda_re = -0.5 + nrm(ks[3], (DEPTH, S5_GROUPS, S5_STATE), 0.01)
    s5_lambda_im = math.pi * n_idx + nrm(ks[4], (DEPTH, S5_GROUPS, S5_STATE), 0.01)
    s5_log_step = jax.random.uniform(ks[5], (DEPTH, S5_GROUPS), f32, math.log(1e-3), math.log(1e-1))
    bstd = (S5_GROUP_CH ** -0.5) / math.sqrt(2.0)
    s5_b_re = nrm(ks[6], (DEPTH, S5_GROUPS, S5_STATE, S5_GROUP_CH), bstd)
    s5_b_im = nrm(ks[7], (DEPTH, S5_GROUPS, S5_STATE, S5_GROUP_CH), bstd)
    cstd = (S5_STATE ** -0.5) / math.sqrt(2.0)
    s5_c_re = nrm(ks[8], (DEPTH, S5_GROUPS, S5_GROUP_CH, S5_STATE), cstd)
    s5_c_im = nrm(ks[9], (DEPTH, S5_GROUPS, S5_GROUP_CH, S5_STATE), cstd)
    s5_d = nrm(ks[10], (DEPTH, S5_GROUPS, S5_GROUP_CH), 1.0)
    s5_w_glu = nrm(ks[11], (DEPTH, W_S5, W_S5), W_S5 ** -0.5)
    s5_b_glu = nrm(ks[12], (DEPTH, W_S5), 0.01)
    lru_conv_w = nrm(ks[13], (DEPTH, CONV_WIDTH, W_LRU), CONV_WIDTH ** -0.5)
    lru_conv_b = nrm(ks[14], (DEPTH, W_LRU), 0.01)
    lru_w_a = nrm(ks[15], (DEPTH, LRU_HEADS, LRU_HEAD_DIM, LRU_HEAD_DIM), LRU_HEAD_DIM ** -0.5)
    lru_b_a = nrm(ks[16], (DEPTH, LRU_HEADS, LRU_HEAD_DIM), 0.01)
    lru_w_x = nrm(ks[17], (DEPTH, LRU_HEADS, LRU_HEAD_DIM, LRU_HEAD_DIM), LRU_HEAD_DIM ** -0.5)
    lru_b_x = nrm(ks[18], (DEPTH, LRU_HEADS, LRU_HEAD_DIM), 0.01)
    a_c = jax.random.uniform(ks[19], (DEPTH, LRU_HEADS, LRU_HEAD_DIM), f32, 0.9, 0.999)
    a0 = a_c ** (1.0 / RG_C)
    lru_lambda = jnp.log(a0) - jnp.log1p(-a0)
    s5_out_g = 1.0 + nrm(ks[20], (DEPTH, W_S5), 0.02)
    lru_out_g = 1.0 + nrm(ks[21], (DEPTH, W_LRU), 0.02)
    w_out = nrm(ks[22], (DEPTH, D_MODEL, D_MODEL), D_MODEL ** -0.5)
    norm2_g = 1.0 + nrm(ks[23], (DEPTH, D_MODEL), 0.02)
    w_gate = nrm(ks[24], (DEPTH, D_MODEL, D_FF), D_MODEL ** -0.5)
    w_up = nrm(ks[25], (DEPTH, D_MODEL, D_FF), D_MODEL ** -0.5)
    w_down = nrm(ks[26], (DEPTH, D_FF, D_MODEL), D_FF ** -0.5)
    final_g = 1.0 + nrm(ks[27], (D_MODEL,), 0.02)
    return {"x": x, "norm1_g": norm1_g, "w_in": w_in,
            "s5_lambda_re": s5_lambda_re, "s5_lambda_im": s5_lambda_im, "s5_log_step": s5_log_step,
            "s5_b_re": s5_b_re, "s5_b_im": s5_b_im, "s5_c_re": s5_c_re, "s5_c_im": s5_c_im,
            "s5_d": s5_d, "s5_w_glu": s5_w_glu, "s5_b_glu": s5_b_glu,
            "lru_conv_w": lru_conv_w, "lru_conv_b": lru_conv_b, "lru_w_a": lru_w_a, "lru_b_a": lru_b_a,
            "lru_w_x": lru_w_x, "lru_b_x": lru_b_x, "lru_lambda": lru_lambda,
            "s5_out_g": s5_out_g, "lru_out_g": lru_out_g, "w_out": w_out,
            "norm2_g": norm2_g, "w_gate": w_gate, "w_up": w_up, "w_down": w_down, "final_g": final_g}


def reference(x, norm1_g, w_in, s5_lambda_re, s5_lambda_im, s5_log_step, s5_b_re, s5_b_im,
              s5_c_re, s5_c_im, s5_d, s5_w_glu, s5_b_glu, lru_conv_w, lru_conv_b, lru_w_a, lru_b_a,
              lru_w_x, lru_b_x, lru_lambda, s5_out_g, lru_out_g, w_out, norm2_g, w_gate, w_up,
              w_down, final_g):
    for l in range(DEPTH):
        h = rms_norm(x, norm1_g[l])
        proj = h @ w_in[l]
        u = proj[..., :W_S5]
        xr = proj[..., W_S5:W_S5 + W_LRU]
        yr = proj[..., W_S5 + W_LRU:]
        s5_out = s5_mixer(u, s5_lambda_re[l], s5_lambda_im[l], s5_log_step[l], s5_b_re[l], s5_b_im[l],
                          s5_c_re[l], s5_c_im[l], s5_d[l], s5_w_glu[l], s5_b_glu[l])
        lru_out = rglru_mixer(xr, yr, lru_conv_w[l], lru_conv_b[l], lru_w_a[l], lru_b_a[l],
                              lru_w_x[l], lru_b_x[l], lru_lambda[l])
        mix = jnp.concatenate([rms_norm(s5_out, s5_out_g[l]), rms_norm(lru_out, lru_out_g[l])], axis=-1)
        x = x + mix @ w_out[l]
        h2 = rms_norm(x, norm2_g[l])
        x = x + (jax.nn.silu(h2 @ w_gate[l]) * (h2 @ w_up[l])) @ w_down[l]
    return rms_norm(x, final_g)
```

```cpp
#include <hip/hip_runtime.h>
#include <cstdio>
#include <cstdint>

#define LAS __attribute__((address_space(3)))
#define GAS __attribute__((address_space(1)))
typedef unsigned short bf16_t;
typedef short bf16x8 __attribute__((ext_vector_type(8)));
typedef float f32x4 __attribute__((ext_vector_type(4)));
typedef float f32x2 __attribute__((ext_vector_type(2)));
typedef unsigned u32x4 __attribute__((ext_vector_type(4)));
typedef unsigned u32x2 __attribute__((ext_vector_type(2)));

#ifndef MK_N_LAUNCHES
#define MK_N_LAUNCHES 10
#endif

constexpr int BATCH = 16, SEQ = 2048, DM = 1024, T = BATCH * SEQ, WS5 = 512, WLRU = 512, DIN = 1536, DFF = 2816;
constexpr int NG = 32, NS = 64, NCHUNK = SEQ / 16, UXW = 384;
constexpr float EPS = 1e-6f;
constexpr int NPH = 10;
constexpr int N_LAUNCHES = MK_N_LAUNCHES;

namespace pg8 {
constexpr int BM = 256, BK = 64, HALF = 128, HTB = HALF * BK * 2, STAGE_BYTES = 8 * HTB, NXCD = 8, WGM = 8;
__host__ __device__ __forceinline__ int lds_byte(int r, int c) { const int st = (r >> 4) * 2 + (c >> 5), rr = r & 15, cc = c & 31, ob = rr * 64 + cc * 2; return st * 1024 + (ob ^ (((ob >> 9) & 1) << 5)); }
__host__ __device__ __forceinline__ void stage_rc(int b, int& R, int& C) { const int st = b / 1024, sb = b % 1024, swz = sb ^ (((sb >> 9) & 1) << 5); R = (st >> 1) * 16 + swz / 64; C = (st & 1) * 32 + (swz % 64) / 2; }
__host__ __device__ __forceinline__ int perm32(int rho) { const int n = rho >> 4, i = rho & 15; return 8 * (i >> 2) + 4 * n + (i & 3); }

struct Unit { int pm, pn, aux; const char* a; const char* b; };
struct Gemm { int lda, ldb, K; };

struct StdOrder {
    int nM, nN, nwg, G, c; const char* A; const char* B; size_t ta, tb;
    __device__ __forceinline__ void init(int M, int N, int G_, int c_, const void* A_, int lda, const void* B_, int ldb) { nM = M / BM; nN = N / BM; nwg = nM * nN; G = G_; c = c_; A = (const char*)A_; B = (const char*)B_; ta = (size_t)BM * lda * 2; tb = (size_t)BM * ldb * 2; }
    __device__ __forceinline__ bool next(int i, Unit& u) const {
        const long L = (long)i * G + c; if (L >= nwg) return false;
        int wgid = (int)L; { const int q = nwg / NXCD, r = nwg % NXCD, xcd = wgid % NXCD, off = wgid / NXCD; wgid = (xcd < r ? xcd * (q + 1) : r * (q + 1) + (xcd - r) * q) + off; }
        const int nig = WGM * nN, gid = wgid / nig, fm = gid * WGM, gsz = (nM - fm) < WGM ? (nM - fm) : WGM;
        u.pm = fm + ((wgid % nig) % gsz); u.pn = (wgid % nig) / gsz; u.aux = 0; u.a = A + (size_t)u.pm * ta; u.b = B + (size_t)u.pn * tb; return true;
    }
};

__device__ __forceinline__ unsigned cvt_pk_bf16(float lo, float hi) { unsigned r; asm volatile("v_cvt_pk_bf16_f32 %0, %1, %2" : "=v"(r) : "v"(lo), "v"(hi)); return r; }

template <class Epi, class Sched, bool ALIGN_EPI>
__device__ __forceinline__ void gemm_phase(LAS unsigned char* lds, const Gemm g, const Sched& S, const Epi& E) {
    const int tid = threadIdx.x, wid = __builtin_amdgcn_readfirstlane(tid >> 6), lane = tid & 63, wr = wid >> 2, wc = wid & 3, fr = lane & 15, fq = lane >> 4;
    const int K = g.K, nt = K / BK;
    unsigned voffA[2], voffB[2];
#pragma unroll
    for (int i = 0; i < 2; ++i) { int R, C; stage_rc(tid * 16 + i * 8192, R, C); const int Rb = Epi::PERM ? ((R & ~31) + perm32(R & 31)) : R;
        voffA[i] = (unsigned)(R * g.lda + C) * 2u; voffB[i] = (unsigned)(Rb * g.ldb + C) * 2u; }
    const size_t kstep = (size_t)(BK * 2);
    const size_t hstepA = (size_t)HALF * g.lda * 2, hstepB = (size_t)HALF * g.ldb * 2;
    const unsigned ldsw = (unsigned)wid * 1024u;
    const int aoff = lds_byte(wr * 64 + fr, fq * 8), boff = lds_byte(wc * 32 + fr, fq * 8);
#define PG8_SA(b, h) (((b) * 2 + (h)) * HTB)
#define PG8_SB(b, h) ((4 + (b) * 2 + (h)) * HTB)
#define PG8_STAGE(bufoff, gbase, voff) do { _Pragma("unroll") for (int _i = 0; _i < 2; ++_i) \
        __builtin_amdgcn_global_load_lds((const unsigned*)((const char*)(gbase) + (voff)[_i]), (LAS unsigned*)(lds + (bufoff) + ldsw + _i * 8192), 16, 0, 0); } while (0)
#define PG8_LDA(dst, b, h) do { _Pragma("unroll") for (int m = 0; m < 4; ++m) _Pragma("unroll") for (int k = 0; k < 2; ++k) dst[m][k] = *(const LAS bf16x8*)(lds + PG8_SA(b, h) + aoff + m * 2048 + k * 1024); } while (0)
#define PG8_LDB(dst, b, h) do { _Pragma("unroll") for (int n = 0; n < 2; ++n) _Pragma("unroll") for (int k = 0; k < 2; ++k) dst[n][k] = *(const LAS bf16x8*)(lds + PG8_SB(b, h) + boff + n * 2048 + k * 1024); } while (0)
#define PG8_MMA(ai, bj, At, Bt) do { __builtin_amdgcn_s_setprio(1); _Pragma("unroll") for (int m = 0; m < 4; ++m) _Pragma("unroll") for (int n = 0; n < 2; ++n) _Pragma("unroll") for (int k = 0; k < 2; ++k) \
        acc[ai][bj][m][n] = __builtin_amdgcn_mfma_f32_16x16x32_bf16(Bt[n][k], At[m][k], acc[ai][bj][m][n], 0, 0, 0); __builtin_amdgcn_s_setprio(0); } while (0)
#define PG8_WAIT_V(n) asm volatile("s_waitcnt vmcnt(" #n ")" ::: "memory")
#define PG8_WAIT_L(n) asm volatile("s_waitcnt lgkmcnt(" #n ")" ::: "memory")
#define PG8_BAR __builtin_amdgcn_s_barrier()
#define PG8_SCHED __builtin_amdgcn_sched_barrier(0)
    Unit cur, nxt; int ui = 0;
    if (!S.next(0, cur)) return;
    f32x4 acc[2][2][4][2];
#pragma unroll
    for (int a = 0; a < 2; ++a)
#pragma unroll
        for (int b = 0; b < 2; ++b)
#pragma unroll
            for (int m = 0; m < 4; ++m)
#pragma unroll
                for (int n = 0; n < 2; ++n) acc[a][b][m][n] = (f32x4){0.f, 0.f, 0.f, 0.f};
    bf16x8 At[4][2], B0[2][2], B1[2][2];
    const char* cA = cur.a; const char* cB = cur.b;
    PG8_STAGE(PG8_SB(0, 0), cB, voffB); PG8_STAGE(PG8_SB(0, 1), cB + hstepB, voffB); PG8_STAGE(PG8_SA(0, 0), cA, voffA); PG8_STAGE(PG8_SA(0, 1), cA + hstepA, voffA);
    if (wr == 1) PG8_BAR;
    PG8_WAIT_V(2); PG8_BAR;
    PG8_STAGE(PG8_SB(1, 0), cB + kstep, voffB); PG8_STAGE(PG8_SA(1, 0), cA + kstep, voffA); PG8_STAGE(PG8_SB(1, 1), cB + hstepB + kstep, voffB);
    PG8_WAIT_V(6); PG8_BAR;
    for (;;) {
        const bool has_next = S.next(ui + 1, nxt);
        const char* nA = has_next ? nxt.a : cA; const char* nB = has_next ? nxt.b : cB;
        for (int t = 0; t < nt; t += 2) {
            const bool last = (t == nt - 2);
            const char* a1 = cA + (size_t)(t + 1) * kstep;
            const char* a2 = last ? nA : cA + (size_t)(t + 2) * kstep; const char* b2 = last ? nB : cB + (size_t)(t + 2) * kstep;
            const char* a3 = a2 + kstep; const char* b3 = b2 + kstep;
            if constexpr (Epi::MIDT > 0) { if (t == Epi::MIDT) E.mid(acc, ui, wr, fr); }
            PG8_LDB(B0, 0, 0); PG8_LDB(B1, 0, 1); PG8_SCHED; PG8_LDA(At, 0, 0); PG8_STAGE(PG8_SA(1, 1), a1 + hstepA, voffA);
            PG8_WAIT_V(8); PG8_WAIT_L(0); PG8_BAR; PG8_MMA(0, 0, At, B0); PG8_MMA(0, 1, At, B1); PG8_BAR; PG8_SCHED;
            PG8_LDA(At, 0, 1); PG8_STAGE(PG8_SB(0, 0), b2, voffB); PG8_STAGE(PG8_SB(0, 1), b2 + hstepB, voffB); PG8_STAGE(PG8_SA(0, 0), a2, voffA);
            PG8_WAIT_V(8); PG8_WAIT_L(0); PG8_BAR; PG8_MMA(1, 0, At, B0); PG8_MMA(1, 1, At, B1); PG8_BAR; PG8_SCHED;
            PG8_LDB(B0, 1, 0); PG8_LDB(B1, 1, 1); PG8_SCHED; PG8_LDA(At, 1, 0); PG8_STAGE(PG8_SA(0, 1), a2 + hstepA, voffA);
            PG8_WAIT_V(8); PG8_WAIT_L(0); PG8_BAR; PG8_MMA(0, 0, At, B0); PG8_MMA(0, 1, At, B1); PG8_BAR; PG8_SCHED;
            PG8_LDA(At, 1, 1); PG8_STAGE(PG8_SB(1, 0), b3, voffB); PG8_STAGE(PG8_SB(1, 1), b3 + hstepB, voffB); PG8_STAGE(PG8_SA(1, 0), a3, voffA);
            PG8_WAIT_V(8); PG8_WAIT_L(0); PG8_BAR; PG8_MMA(1, 0, At, B0); PG8_MMA(1, 1, At, B1); PG8_BAR; PG8_SCHED;
        }
        if constexpr (ALIGN_EPI) { if (wr == 0) PG8_BAR; }
        E(acc, cur, ui, wr, wc, fr, fq);
        if (!has_next) break;
#pragma unroll
        for (int a = 0; a < 2; ++a)
#pragma unroll
            for (int b = 0; b < 2; ++b)
#pragma unroll
                for (int m = 0; m < 4; ++m)
#pragma unroll
                    for (int n = 0; n < 2; ++n) acc[a][b][m][n] = (f32x4){0.f, 0.f, 0.f, 0.f};
        cur = nxt; cA = nA; cB = nB; ++ui;
        if constexpr (ALIGN_EPI) { if (wr == 1) PG8_BAR; }
    }
    PG8_WAIT_V(0);
    if constexpr (!ALIGN_EPI) { if (wr == 0) PG8_BAR; }
    PG8_BAR;
#undef PG8_SA
#undef PG8_SB
#undef PG8_STAGE
#undef PG8_LDA
#undef PG8_LDB
#undef PG8_MMA
#undef PG8_WAIT_V
#undef PG8_WAIT_L
#undef PG8_BAR
#undef PG8_SCHED
}
}
using pg8::Unit; using pg8::cvt_pk_bf16;

constexpr size_t MiB = 1u << 20;
constexpr size_t WS_CTL = 0, CTL_ZERO_BYTES = 64 * 1024;
constexpr size_t WS_WIN = 1 * MiB;
constexpr size_t WS_WGLU = 4 * MiB;
constexpr size_t WS_WGATE4 = 4 * MiB + 512 * 1024;
constexpr size_t WS_WOUT = 5 * MiB;
constexpr size_t WS_WGU = 7 * MiB;
constexpr size_t WS_WD = 18 * MiB;
constexpr size_t WS_BTA = 24 * MiB;
constexpr size_t WS_BTC = 28 * MiB;
constexpr size_t WS_PW16 = 34 * MiB;
constexpr size_t WS_LS8 = 34 * MiB + 64 * 1024;
constexpr size_t WS_SS5 = 35 * MiB;
constexpr size_t WS_SSL = 36 * MiB;
constexpr size_t WS_SSX = 37 * MiB;
constexpr size_t WS_H = 40 * MiB;
constexpr size_t WS_X1B = 40 * MiB;
constexpr size_t WS_UX = 104 * MiB;
constexpr size_t WS_XR = 152 * MiB;
constexpr size_t WS_YR = 184 * MiB;
constexpr size_t WS_XC = 216 * MiB;
constexpr size_t WS_V = 248 * MiB;
constexpr size_t WS_LG = 280 * MiB;
constexpr size_t WS_Z = 344 * MiB;
constexpr size_t WS_MIX = 376 * MiB;
constexpr size_t WS_X1 = 104 * MiB;
constexpr size_t WS_ACT = 232 * MiB;
constexpr size_t WS_END = 440 * MiB;
static_assert(WS_X1 + (size_t)T * DM * 4 <= WS_ACT && WS_ACT + (size_t)T * DFF * 2 <= WS_END && WS_MIX + (size_t)T * DM * 2 <= WS_END, "d_ws map");
constexpr int CW_BAR = 4096;

constexpr int RING_BYTES = 131072, TAB_OFF = RING_BYTES, TAB_BYTES = 12288, MISC_OFF = TAB_OFF + TAB_BYTES, LDS_BYTES = 147456;
static_assert(MISC_OFF + 128 + 256 <= LDS_BYTES, "LDS map");

#define LDS_WAIT() asm volatile("s_waitcnt lgkmcnt(0)" ::: "memory")
#define VM_WAIT() asm volatile("s_waitcnt vmcnt(0)" ::: "memory")
__device__ __forceinline__ float bflo(unsigned w) { return __builtin_bit_cast(float, w << 16); }
__device__ __forceinline__ float bfhi(unsigned w) { return __builtin_bit_cast(float, w & 0xffff0000u); }
__device__ __forceinline__ float sigmoidf_(float x) { return __builtin_amdgcn_rcpf(1.0f + __expf(-x)); }
__device__ __forceinline__ float gelu_tanh(float x) { const float u = 1.5957691216057308f * (x + 0.044715f * x * x * x); return x * sigmoidf_(u); }
__device__ __forceinline__ float neg_expm1(float x) {
    const float p = x * (1.0f + x * (0.5f + x * (0.16666667f + x * (0.041666668f + x * (0.0083333338f + x * 0.0013888889f)))));
    return (x > -0.25f) ? -p : 1.0f - __expf(x);
}
__device__ __forceinline__ float wave_sum(float v) {
#pragma unroll
    for (int o = 1; o < 64; o <<= 1) v += __shfl_xor(v, o);
    return v;
}

#define XB_TMO      128
#define XB_XCNT(j)  (256  + 64 * (j))
#define XB_XSUB(j)  (1280 + 64 * (j))
#define XB_XGEN(j)  (2304 + 64 * (j))
#define XB_TOP      3328
#define XB_TOPGEN   3392
#define XCD_BAR_WORDS 3456
#define XB_SPIN_CAP (1u << 18)
__device__ __forceinline__ unsigned xb_ld(unsigned* p)              { return __hip_atomic_load(p, __ATOMIC_RELAXED, __HIP_MEMORY_SCOPE_AGENT); }
__device__ __forceinline__ unsigned xb_add(unsigned* p, unsigned v) { return __hip_atomic_fetch_add(p, v, __ATOMIC_RELAXED, __HIP_MEMORY_SCOPE_AGENT); }
__device__ __forceinline__ unsigned xb_xcc_id() { return (unsigned)__builtin_amdgcn_s_getreg((3 << 11) | 20) & 0xFu; }
#define XB_SPIN(cond, bar) do { unsigned _sp = 0; while (cond) { __builtin_amdgcn_s_sleep(1); \
    if ((++_sp & 255u) == 0u) { if (xb_ld(&(bar)[XB_TMO])) break; if (_sp > XB_SPIN_CAP) { atomicAdd(&(bar)[XB_TMO], 1u); break; } } } } while (0)
struct XcdBarrier { unsigned* bar; unsigned x; volatile LAS unsigned* st; };
__device__ __forceinline__ XcdBarrier xcd_barrier_post(unsigned* bar, volatile LAS unsigned* st) {
    XcdBarrier b; b.bar = bar; b.x = xb_xcc_id(); b.st = st;
    if (threadIdx.x == 0) (void)xb_add(&bar[XB_XCNT(b.x)], 1u);
    return b;
}
__device__ __forceinline__ void xcd_barrier_complete(unsigned* bar, unsigned x, unsigned& nloc, unsigned& nx) {
    const unsigned G = gridDim.x * gridDim.y * gridDim.z;
    unsigned sum, cnt, mine, sp = 0u;
    for (;;) {
        sum = 0u; cnt = 0u; mine = 0u;
#pragma unroll
        for (unsigned j = 0; j < 16; ++j) { const unsigned c = xb_ld(&bar[XB_XCNT(j)]); sum += c; cnt += (c > 0u) ? 1u : 0u; mine = (j == x) ? c : mine; }
        if (sum == G) break;
        __builtin_amdgcn_s_sleep(1);
        if ((++sp & 255u) == 0u) { if (xb_ld(&bar[XB_TMO])) break; if (sp > XB_SPIN_CAP) { atomicAdd(&bar[XB_TMO], 1u); break; } }
    }
    nloc = mine > 0u ? mine : 1u; nx = cnt > 0u ? cnt : 1u;
}
__device__ __forceinline__ void xcd_barrier(const XcdBarrier& b) {
    asm volatile("s_waitcnt vmcnt(0)" ::: "memory");
    __syncthreads();
    if (threadIdx.x == 0) {
        unsigned* bar = b.bar;
        __builtin_amdgcn_s_waitcnt(0);
        unsigned nloc = b.st[0], nx = b.st[1];
        if (nloc == 0u) { xcd_barrier_complete(bar, b.x, nloc, nx); b.st[0] = nloc; b.st[1] = nx; }
        const unsigned old = xb_add(&bar[XB_XSUB(b.x)], 1u);
        const unsigned gen = old / nloc;
        if (old + 1u == (gen + 1u) * nloc) {
            __builtin_amdgcn_fence(__ATOMIC_RELEASE, "agent");
            asm volatile("s_waitcnt vmcnt(0)" ::: "memory");
            const unsigned og = xb_add(&bar[XB_TOP], 1u);
            const unsigned tg = og / nx;
            if (og + 1u == (tg + 1u) * nx) xb_add(&bar[XB_TOPGEN], 1u);
            else XB_SPIN(xb_ld(&bar[XB_TOPGEN]) == tg, bar);
            __builtin_amdgcn_fence(__ATOMIC_ACQUIRE, "agent");
            xb_add(&bar[XB_XGEN(b.x)], 1u);
            asm volatile("s_waitcnt vmcnt(0)" ::: "memory");
        } else {
            XB_SPIN(xb_ld(&bar[XB_XGEN(b.x)]) == gen, bar);
            __builtin_amdgcn_fence(__ATOMIC_ACQUIRE, "agent");
            asm volatile("s_waitcnt vmcnt(0)" ::: "memory");
        }
    }
    __syncthreads();
}

struct Args { const float* in[28]; float* out; unsigned char* ws; int ph_lo, ph_hi, li, pad; };
enum { I_X = 0, I_G1, I_WIN, I_LRE, I_LIM, I_LSTEP, I_BRE, I_BIM, I_CRE, I_CIM, I_D, I_WGLU, I_BGLU, I_CW, I_CB, I_WA, I_BA, I_WX, I_BX, I_LLAM, I_GS5, I_GLRU, I_WOUT, I_G2, I_WG, I_WU, I_WD, I_GF };

__device__ __forceinline__ const float* inp(const LAS unsigned* pt, int i) {
    const unsigned lo = __builtin_amdgcn_readfirstlane(pt[2 * i]), hi = __builtin_amdgcn_readfirstlane(pt[2 * i + 1]);
    return (const float*)(const GAS float*)(((unsigned long long)hi << 32) | lo);
}
__device__ __forceinline__ void p0_transpose_item(const float* W, int K, int N, bf16_t* WT, int rowbase, const float* sc0, const float* sc1, LAS float* scr, int k0, int n0, int lane) {
#pragma unroll 8
    for (int i = 0; i < 32; ++i) { const int kk = 2 * i + (lane >> 5), k = k0 + kk; float s = 1.f; if (sc0) s = (k < 512 || !sc1) ? sc0[k] : sc1[k - 512];
        scr[kk * 33 + (lane & 31)] = W[(size_t)k * N + n0 + (lane & 31)] * s; }
    LDS_WAIT(); asm volatile("" ::: "memory");
    const int c = lane & 7;
#pragma unroll
    for (int j = 0; j < 4; ++j) { const int n = (lane >> 3) + 8 * j; const LAS float* s = scr + (8 * c) * 33 + n;
        u32x4 o; o.x = cvt_pk_bf16(s[0 * 33], s[1 * 33]); o.y = cvt_pk_bf16(s[2 * 33], s[3 * 33]); o.z = cvt_pk_bf16(s[4 * 33], s[5 * 33]); o.w = cvt_pk_bf16(s[6 * 33], s[7 * 33]);
        *(u32x4*)(WT + (size_t)(rowbase + n) * K + k0 + 8 * c) = o; }
    LDS_WAIT(); asm volatile("" ::: "memory");
}
__device__ __forceinline__ void p0_s5_tables(const LAS unsigned* pt, unsigned char* wsp, int g, LAS unsigned char* lds, int tid) {
    LAS f32x2* pw = (LAS f32x2*)lds;
    LAS f32x2* bb = (LAS f32x2*)(lds + 16384);
    LAS f32x2* cc = (LAS f32x2*)(lds + 32768);
    LAS float* kt = (LAS float*)(lds + 49152);
    const float* lre = inp(pt, I_LRE) + g * NS; const float* lim = inp(pt, I_LIM) + g * NS;
    const double dt = exp((double)inp(pt, I_LSTEP)[g]);
    for (int idx = tid; idx < NS * 17; idx += 512) { const int n = idx / 17, p = idx % 17;
        const double re = fmin((double)lre[n], -1e-4), im = (double)lim[n]; const double e = exp(re * dt * p); double s, c; sincos(im * dt * p, &s, &c);
        pw[idx] = (f32x2){(float)(e * c), (float)(e * s)}; }
    for (int idx = tid; idx < NS * 16; idx += 512) { const int n = idx >> 4, ci = idx & 15;
        const double re = fmin((double)lre[n], -1e-4), im = (double)lim[n]; const double e = exp(re * dt); double s, c; sincos(im * dt, &s, &c);
        const double nr = e * c - 1.0, ni = e * s, den = re * re + im * im; const double qr = (nr * re + ni * im) / den, qi = (ni * re - nr * im) / den;
        const double br = (double)inp(pt, I_BRE)[(g * NS + n) * 16 + ci], bi = (double)inp(pt, I_BIM)[(g * NS + n) * 16 + ci];
        bb[idx] = (f32x2){(float)(qr * br - qi * bi), (float)(qr * bi + qi * br)}; }
    for (int idx = tid; idx < 16 * NS; idx += 512) cc[idx] = (f32x2){inp(pt, I_CRE)[g * 16 * NS + idx], inp(pt, I_CIM)[g * 16 * NS + idx]};
    if (tid < NS) ((f32x2*)(wsp + WS_PW16))[g * NS + tid] = pw[tid * 17 + 16];
    __syncthreads();
    for (int idx = tid; idx < 4096; idx += 512) { const int tau = idx >> 8, co = (idx >> 4) & 15, ci = idx & 15; float s = 0.f;
        for (int n = 0; n < NS; ++n) { const f32x2 C = cc[co * NS + n], P = pw[n * 17 + tau], B = bb[n * 16 + ci];
            const float wr_ = C.x * P.x - C.y * P.y, wi_ = C.x * P.y + C.y * P.x; s += wr_ * B.x - wi_ * B.y; }
        if (tau == 0 && co == ci) s += inp(pt, I_D)[g * 16 + co];
        kt[idx] = s; }
    __syncthreads();
    unsigned* bta = (unsigned*)(wsp + WS_BTA) + (size_t)g * 256 * 128;
    for (int idx = tid; idx < 256 * 128; idx += 512) { const int row = idx >> 7, k = (idx & 127) * 2; float v[2] = {0.f, 0.f};
        if (row < 128) { const int n = row >> 1, part = row & 1;
#pragma unroll
            for (int e = 0; e < 2; ++e) { const int jp = (k + e) >> 4, ci = (k + e) & 15; const f32x2 P = pw[n * 17 + 15 - jp], B = bb[n * 16 + ci];
                v[e] = part ? (P.x * B.y + P.y * B.x) : (P.x * B.x - P.y * B.y); } }
        bta[idx] = cvt_pk_bf16(v[0], v[1]); }
    unsigned* btc = (unsigned*)(wsp + WS_BTC) + (size_t)g * 256 * 192;
    for (int idx = tid; idx < 256 * 192; idx += 512) { const int row = idx / 192, k = (idx % 192) * 2, j = row >> 4, co = row & 15; float v[2];
#pragma unroll
        for (int e = 0; e < 2; ++e) { const int kk = k + e;
            if (kk < 256) { const int jp = kk >> 4, ci = kk & 15; v[e] = (jp <= j) ? kt[((j - jp) << 8) + (co << 4) + ci] : 0.f; }
            else { const int n = (kk - 256) >> 1, part = kk & 1; const f32x2 C = cc[co * NS + n], P = pw[n * 17 + j + 1];
                v[e] = part ? -(C.x * P.y + C.y * P.x) : (C.x * P.x - C.y * P.y); } }
        btc[idx] = cvt_pk_bf16(v[0], v[1]); }
    __syncthreads();
}
__device__ __forceinline__ void p0_prologue(const LAS unsigned* pt, unsigned char* wsp, LAS unsigned char* lds, int tid, int lane, int wave, int vcu, int G) {
    const int bx = blockIdx.x;
    if (bx < NG) p0_s5_tables(pt, wsp, bx, lds, tid);
    if (bx == NG) { if (tid < WLRU) { const float x = inp(pt, I_LLAM)[tid]; ((float*)(wsp + WS_LS8))[tid] = 8.0f * (fminf(x, 0.f) - log1pf(expf(-fabsf(x)))); } }
    { unsigned* wg4 = (unsigned*)(wsp + WS_WGATE4);
      for (int idx = bx * 512 + tid; idx < 4 * 256 * 128; idx += G * 512) { const int q = idx >> 15, j = (idx >> 7) & 255, k = (idx & 127) * 2; const int ch = 128 * q + (j & 127), h = ch >> 6, jo = ch & 63;
          const float* w = (j >> 7) ? inp(pt, I_WX) : inp(pt, I_WA); float v[2];
#pragma unroll
          for (int e = 0; e < 2; ++e) { const int ci = 256 * (q >> 1) + k + e; v[e] = ((ci >> 6) == h) ? w[(h * 64 + (ci & 63)) * 64 + jo] : 0.f; }
          wg4[idx] = cvt_pk_bf16(v[0], v[1]); } }
    LAS float* scr = (LAS float*)(lds + wave * 16384);
    const int gw = vcu * 8 + wave, NGW = G * 8;
    constexpr int I_IN = (DM / 64) * (DIN / 32), I_GL = (WS5 / 64) * (WS5 / 32), I_OU = (DM / 64) * (DM / 32), I_GA = (DM / 64) * (DFF / 32), I_DN = (DFF / 64) * (DM / 32);
    constexpr int NITEMS = I_IN + I_GL + I_OU + 2 * I_GA + I_DN;
    for (int it = gw; it < NITEMS; it += NGW) {
        int r = it;
        if (r < I_IN) { const int nb = DIN / 32, k0 = 64 * (r / nb), n0 = 32 * (r % nb); p0_transpose_item(inp(pt, I_WIN), DM, DIN, (bf16_t*)(wsp + WS_WIN), n0, nullptr, nullptr, scr, k0, n0, lane); continue; } r -= I_IN;
        if (r < I_GL) { const int nb = WS5 / 32, k0 = 64 * (r / nb), n0 = 32 * (r % nb); p0_transpose_item(inp(pt, I_WGLU), WS5, WS5, (bf16_t*)(wsp + WS_WGLU), n0, nullptr, nullptr, scr, k0, n0, lane); continue; } r -= I_GL;
        if (r < I_OU) { const int nb = DM / 32, k0 = 64 * (r / nb), n0 = 32 * (r % nb); p0_transpose_item(inp(pt, I_WOUT), DM, DM, (bf16_t*)(wsp + WS_WOUT), n0, inp(pt, I_GS5), inp(pt, I_GLRU), scr, k0, n0, lane); continue; } r -= I_OU;
        if (r < I_GA) { const int nb = DFF / 32, k0 = 64 * (r / nb), n0 = 32 * (r % nb); p0_transpose_item(inp(pt, I_WG), DM, DFF, (bf16_t*)(wsp + WS_WGU), 256 * (n0 >> 7) + (n0 & 127), inp(pt, I_G2), nullptr, scr, k0, n0, lane); continue; } r -= I_GA;
        if (r < I_GA) { const int nb = DFF / 32, k0 = 64 * (r / nb), n0 = 32 * (r % nb); p0_transpose_item(inp(pt, I_WU), DM, DFF, (bf16_t*)(wsp + WS_WGU), 256 * (n0 >> 7) + 128 + (n0 & 127), inp(pt, I_G2), nullptr, scr, k0, n0, lane); continue; } r -= I_GA;
        { const int nb = DM / 32, k0 = 64 * (r / nb), n0 = 32 * (r % nb); p0_transpose_item(inp(pt, I_WD), DFF, DM, (bf16_t*)(wsp + WS_WD), n0, nullptr, nullptr, scr, k0, n0, lane); }
    }
    const f32x4* g1 = (const f32x4*)inp(pt, I_G1) + lane; f32x4 gv[4];
#pragma unroll
    for (int j = 0; j < 4; ++j) gv[j] = g1[64 * j];
    for (int m = gw; m < T; m += NGW) {
        const f32x4* xr = (const f32x4*)(inp(pt, I_X) + (size_t)m * DM) + lane; f32x4 v[4]; float s = 0.f;
#pragma unroll
        for (int j = 0; j < 4; ++j) { v[j] = xr[64 * j]; s += (v[j].x * v[j].x + v[j].y * v[j].y) + (v[j].z * v[j].z + v[j].w * v[j].w); }
        const float rs = 1.0f / sqrtf(wave_sum(s) * (1.f / DM) + EPS);
        u32x2* o = (u32x2*)((bf16_t*)(wsp + WS_H) + (size_t)m * DM) + lane;
#pragma unroll
        for (int j = 0; j < 4; ++j) { u32x2 w; w.x = cvt_pk_bf16(v[j].x * rs * gv[j].x, v[j].y * rs * gv[j].y); w.y = cvt_pk_bf16(v[j].z * rs * gv[j].z, v[j].w * rs * gv[j].w); o[64 * j] = w; }
    }
}

#define EPI_ROWS _Pragma("unroll") for (int ai = 0; ai < 2; ++ai) _Pragma("unroll") for (int m = 0; m < 4; ++m)
typedef f32x4 Acc[2][2][4][2];

struct EpiInProj {
    static constexpr bool PERM = true; static constexpr int MIDT = 0;
    bf16_t *UX, *XR, *YR;
    __device__ __forceinline__ void operator()(const Acc& acc, const Unit& u, int, int wr, int wc, int fr, int fq) const {
        EPI_ROWS { const int row = u.pm * 256 + ai * 128 + wr * 64 + m * 16 + fr, b = row >> 11, t = row & 2047;
#pragma unroll
            for (int bj = 0; bj < 2; ++bj) { const int cit = bj * 128 + wc * 32 + fq * 8; const f32x4 v0 = acc[ai][bj][m][0], v1 = acc[ai][bj][m][1];
                u32x4 w; w.x = cvt_pk_bf16(v0[0], v0[1]); w.y = cvt_pk_bf16(v0[2], v0[3]); w.z = cvt_pk_bf16(v1[0], v1[1]); w.w = cvt_pk_bf16(v1[2], v1[3]);
                bf16_t* dst;
                if (u.pn < 2) { const int col = u.pn * 256 + cit, g = col >> 4, half = (col >> 3) & 1; dst = UX + ((size_t)((g * 16 + b) * NCHUNK + (t >> 4))) * UXW + (t & 15) * 16 + half * 8; }
                else if (u.pn < 4) dst = XR + (size_t)row * WLRU + (u.pn - 2) * 256 + cit;
                else dst = YR + (size_t)row * WLRU + (u.pn - 4) * 256 + cit;
                *(u32x4*)dst = w; } }
    }
};
struct EpiS5A {
    static constexpr bool PERM = false; static constexpr int MIDT = 0;
    float* V;
    __device__ __forceinline__ void operator()(const Acc& acc, const Unit& u, int, int wr, int wc, int fr, int fq) const {
        EPI_ROWS { const int rowg = u.pm * 256 + ai * 128 + wr * 64 + m * 16 + fr;
#pragma unroll
            for (int n = 0; n < 2; ++n) *(f32x4*)(V + (size_t)rowg * 128 + wc * 32 + n * 16 + fq * 4) = acc[ai][0][m][n]; }
    }
};
struct EpiGate {
    static constexpr bool PERM = true; static constexpr int MIDT = 0;
    const bf16_t* XC; unsigned* LG; const float *ba, *bx, *ls8;
    __device__ __forceinline__ void operator()(const Acc& acc, const Unit& u, int, int wr, int wc, int fr, int fq) const {
        const int ch0 = u.pn * 128 + wc * 32 + fq * 8;
        float cba[8], cbx[8], cls[8];
#pragma unroll
        for (int e = 0; e < 8; ++e) { cba[e] = ba[ch0 + e]; cbx[e] = bx[ch0 + e]; cls[e] = ls8[ch0 + e]; }
        EPI_ROWS { const int row = u.pm * 256 + ai * 128 + wr * 64 + m * 16 + fr;
            const u32x4 xw = *(const u32x4*)(XC + (size_t)row * WLRU + ch0); unsigned o[8];
#pragma unroll
            for (int e = 0; e < 8; ++e) { const float ra = acc[ai][0][m][e >> 2][e & 3], ia = acc[ai][1][m][e >> 2][e & 3];
                const unsigned xwe = xw[e >> 1]; const float xc = (e & 1) ? bfhi(xwe) : bflo(xwe);
                const float r = sigmoidf_(ra + cba[e]), ig = sigmoidf_(ia + cbx[e]); const float la = r * cls[e];
                o[e] = cvt_pk_bf16(la, __builtin_amdgcn_sqrtf(fmaxf(1.0f - __expf(2.0f * la), 0.f)) * (ig * xc)); }
            unsigned* dst = LG + (size_t)row * WLRU + ch0;
            *(u32x4*)dst = (u32x4){o[0], o[1], o[2], o[3]}; *(u32x4*)(dst + 4) = (u32x4){o[4], o[5], o[6], o[7]}; asm volatile("" ::: "memory"); }
    }
};
struct EpiS5C {
    static constexpr bool PERM = true; static constexpr int MIDT = 0;
    bf16_t* Z;
    __device__ __forceinline__ void operator()(const Acc& acc, const Unit& u, int, int wr, int wc, int fr, int fq) const {
        const int g = u.aux;
        EPI_ROWS { const int rowg = (u.pm & 7) * 256 + ai * 128 + wr * 64 + m * 16 + fr, b = rowg >> 7, c = rowg & 127;
#pragma unroll
            for (int bj = 0; bj < 2; ++bj) { const int cit = bj * 128 + wc * 32 + fq * 8, j = cit >> 4, half = (cit >> 3) & 1; const f32x4 v0 = acc[ai][bj][m][0], v1 = acc[ai][bj][m][1];
                u32x4 w; w.x = cvt_pk_bf16(gelu_tanh(v0[0]), gelu_tanh(v0[1])); w.y = cvt_pk_bf16(gelu_tanh(v0[2]), gelu_tanh(v0[3]));
                w.z = cvt_pk_bf16(gelu_tanh(v1[0]), gelu_tanh(v1[1])); w.w = cvt_pk_bf16(gelu_tanh(v1[2]), gelu_tanh(v1[3]));
                *(u32x4*)(Z + ((size_t)(b * SEQ + c * 16 + j)) * WS5 + g * 16 + half * 8) = w; } }
    }
};
struct EpiGlu {
    static constexpr bool PERM = true; static constexpr int MIDT = 0;
    const bf16_t* Z; bf16_t* MIX; const float* bglu; float *SS5, *SSL;
    __device__ __forceinline__ void operator()(const Acc& acc, const Unit& u, int, int wr, int wc, int fr, int fq) const {
        float bv[2][8];
#pragma unroll
        for (int bj = 0; bj < 2; ++bj)
#pragma unroll
            for (int e = 0; e < 8; ++e) bv[bj][e] = bglu[u.pn * 256 + bj * 128 + wc * 32 + fq * 8 + e];
        EPI_ROWS { const int row = u.pm * 256 + ai * 128 + wr * 64 + m * 16 + fr; float s1 = 0.f, s2 = 0.f;
#pragma unroll
            for (int bj = 0; bj < 2; ++bj) { const int col = u.pn * 256 + bj * 128 + wc * 32 + fq * 8;
                const u32x4 zw = *(const u32x4*)(Z + (size_t)row * WS5 + col); const u32x4 lw = *(const u32x4*)(MIX + (size_t)row * DM + WS5 + col); float o[8];
#pragma unroll
                for (int e = 0; e < 8; ++e) { const unsigned zz = zw[e >> 1], ll = lw[e >> 1]; const float z = (e & 1) ? bfhi(zz) : bflo(zz), l = (e & 1) ? bfhi(ll) : bflo(ll);
                    o[e] = z * sigmoidf_(acc[ai][bj][m][e >> 2][e & 3] + bv[bj][e]); s1 += o[e] * o[e]; s2 += l * l; }
                u32x4 w; w.x = cvt_pk_bf16(o[0], o[1]); w.y = cvt_pk_bf16(o[2], o[3]); w.z = cvt_pk_bf16(o[4], o[5]); w.w = cvt_pk_bf16(o[6], o[7]);
                *(u32x4*)(MIX + (size_t)row * DM + col) = w; }
            s1 += __shfl_xor(s1, 16); s1 += __shfl_xor(s1, 32); s2 += __shfl_xor(s2, 16); s2 += __shfl_xor(s2, 32);
            if (fq == 0) { SS5[(size_t)row * 8 + u.pn * 4 + wc] = s1; SSL[(size_t)row * 8 + u.pn * 4 + wc] = s2; } }
    }
};
struct EpiOut {
    static constexpr bool PERM = true; static constexpr int MIDT = 8;
    const float* X; float* X1; bf16_t* X1B; float* SSX; const LAS float* tab;
    __device__ __forceinline__ void mid(Acc& acc, int ui, int wr, int fr) const {
        EPI_ROWS { const float r = tab[(ui * 256 + ai * 128 + wr * 64 + m * 16 + fr) * 2];
#pragma unroll
            for (int bj = 0; bj < 2; ++bj) { acc[ai][bj][m][0] *= r; acc[ai][bj][m][1] *= r; } }
    }
    __device__ __forceinline__ void operator()(const Acc& acc, const Unit& u, int ui, int wr, int wc, int fr, int fq) const {
        EPI_ROWS { const int rit = ai * 128 + wr * 64 + m * 16 + fr, row = u.pm * 256 + rit; const float rs2 = tab[(ui * 256 + rit) * 2 + 1]; float ss = 0.f;
#pragma unroll
            for (int bj = 0; bj < 2; ++bj) { const size_t off = (size_t)row * DM + u.pn * 256 + bj * 128 + wc * 32 + fq * 8;
                const f32x4 x0 = *(const f32x4*)(X + off), x1 = *(const f32x4*)(X + off + 4);
                const f32x4 v0 = x0 + acc[ai][bj][m][0] * rs2, v1 = x1 + acc[ai][bj][m][1] * rs2;
                *(f32x4*)(X1 + off) = v0; *(f32x4*)(X1 + off + 4) = v1;
                u32x4 w; w.x = cvt_pk_bf16(v0[0], v0[1]); w.y = cvt_pk_bf16(v0[2], v0[3]); w.z = cvt_pk_bf16(v1[0], v1[1]); w.w = cvt_pk_bf16(v1[2], v1[3]);
                *(u32x4*)(X1B + off) = w;
                ss += (v0[0] * v0[0] + v0[1] * v0[1]) + (v0[2] * v0[2] + v0[3] * v0[3]) + (v1[0] * v1[0] + v1[1] * v1[1]) + (v1[2] * v1[2] + v1[3] * v1[3]); }
            ss += __shfl_xor(ss, 16); ss += __shfl_xor(ss, 32);
            if (fq == 0) SSX[(size_t)row * 16 + u.pn * 4 + wc] = ss; }
    }
};
struct EpiGateUp {
    static constexpr bool PERM = true; static constexpr int MIDT = 0;
    bf16_t* ACT; const LAS float* tab;
    __device__ __forceinline__ void operator()(const Acc& acc, const Unit& u, int ui, int wr, int wc, int fr, int fq) const {
        EPI_ROWS { const int rit = ai * 128 + wr * 64 + m * 16 + fr, row = u.pm * 256 + rit; const float rs = tab[ui * 256 + rit]; float o[8];
#pragma unroll
            for (int e = 0; e < 8; ++e) { const float gv = rs * acc[ai][0][m][e >> 2][e & 3], uv = rs * acc[ai][1][m][e >> 2][e & 3]; o[e] = gv * sigmoidf_(gv) * uv; }
            u32x4 w; w.x = cvt_pk_bf16(o[0], o[1]); w.y = cvt_pk_bf16(o[2], o[3]); w.z = cvt_pk_bf16(o[4], o[5]); w.w = cvt_pk_bf16(o[6], o[7]);
            *(u32x4*)(ACT + (size_t)row * DFF + u.pn * 128 + wc * 32 + fq * 8) = w; }
    }
};
struct EpiDown {
    static constexpr bool PERM = true; static constexpr int MIDT = 0;
    const float* X1; float* OUT;
    __device__ __forceinline__ void operator()(const Acc& acc, const Unit& u, int, int wr, int wc, int fr, int fq) const {
        EPI_ROWS { const int row = u.pm * 256 + ai * 128 + wr * 64 + m * 16 + fr;
#pragma unroll
            for (int bj = 0; bj < 2; ++bj) { const size_t off = (size_t)row * DM + u.pn * 256 + bj * 128 + wc * 32 + fq * 8;
                const f32x4 x0 = *(const f32x4*)(X1 + off), x1 = *(const f32x4*)(X1 + off + 4);
                *(f32x4*)(OUT + off) = x0 + acc[ai][bj][m][0]; *(f32x4*)(OUT + off + 4) = x1 + acc[ai][bj][m][1]; } }
    }
};

struct S5Order {
    int G, c; const char* A; const char* B; size_t tb;
    __device__ __forceinline__ bool next(int i, Unit& u) const { const int L = i * G + c; if (L >= NG * 8) return false;
        const int g = (L & 7) * 4 + ((L >> 6) & 3), rt = (L >> 3) & 7;
        u.pm = g * 8 + rt; u.pn = 0; u.aux = g; u.a = A + (size_t)u.pm * 256 * UXW * 2; u.b = B + (size_t)g * tb; return true; }
};
struct GateOrder {
    int G, c; const char* A; const char* B;
    __device__ __forceinline__ bool next(int i, Unit& u) const { const int L = i * G + c; if (L >= (T / 256) * 4) return false;
        u.pm = L >> 2; u.pn = L & 3; u.aux = 0; u.a = A + ((size_t)u.pm * 256 * WLRU + (u.pn >> 1) * 256) * 2; u.b = B + (size_t)u.pn * 256 * 256 * 2; return true; }
};

__global__ void __launch_bounds__(512, 2) hybrid_fwd(Args args) {
    extern __shared__ __attribute__((aligned(16))) unsigned char lds_[];
    LAS unsigned char* lds = (LAS unsigned char*)lds_;
    volatile LAS unsigned* MISC = (volatile LAS unsigned*)(lds + MISC_OFF);
    const int tid = threadIdx.x, lane = tid & 63, wave = __builtin_amdgcn_readfirstlane(tid >> 6);
    const int G = gridDim.x, bx = blockIdx.x, vcu = (G % 8 == 0) ? (bx % 8) * (G / 8) + bx / 8 : bx;
    unsigned* ctl = (unsigned*)(args.ws + WS_CTL);
    if (tid < 32) MISC[tid] = 0u;
    const LAS unsigned* pt = (const LAS unsigned*)(lds + MISC_OFF + 128);
    if (tid < 28) { const unsigned long long p = (unsigned long long)args.in[tid]; ((LAS unsigned*)pt)[2 * tid] = (unsigned)p; ((LAS unsigned*)pt)[2 * tid + 1] = (unsigned)(p >> 32); }
    __syncthreads();
    XcdBarrier bar; bar.bar = ctl + CW_BAR; bar.x = 0; bar.st = nullptr;
    if (N_LAUNCHES == 1) bar = xcd_barrier_post(ctl + CW_BAR, MISC + 8);
    const int lo = args.ph_lo, hi = args.ph_hi;
#ifndef PH_MASK
#define PH_MASK 0x3ff
#endif
#define IN(k) ((((PH_MASK) >> (k)) & 1) && lo <= (k) && (k) < hi)
#define SEAM(k) do { if (IN(k) && IN((k) + 1)) xcd_barrier(bar); } while (0)

#define H   ((bf16_t*)(args.ws + WS_H))
#define UX  ((bf16_t*)(args.ws + WS_UX))
#define XR  ((bf16_t*)(args.ws + WS_XR))
#define YR  ((bf16_t*)(args.ws + WS_YR))
#define XC  ((bf16_t*)(args.ws + WS_XC))
#define V   ((float*)(args.ws + WS_V))
#define LG  ((unsigned*)(args.ws + WS_LG))
#define Z   ((bf16_t*)(args.ws + WS_Z))
#define MIX ((bf16_t*)(args.ws + WS_MIX))
#define X1  ((float*)(args.ws + WS_X1))
#define X1B ((bf16_t*)(args.ws + WS_X1B))
#define ACT ((bf16_t*)(args.ws + WS_ACT))
#define SS5 ((float*)(args.ws + WS_SS5))
#define SSL ((float*)(args.ws + WS_SSL))
#define SSX ((float*)(args.ws + WS_SSX))
#define tab ((LAS float*)(lds + TAB_OFF))

    if (IN(0)) { p0_prologue(pt, args.ws, lds, tid, lane, wave, vcu, G); SEAM(0); }

    if (IN(1)) {
        pg8::Gemm g{DM, DM, DM}; pg8::StdOrder S; S.init(T, DIN, G, bx, H, DM, args.ws + WS_WIN, DM);
        EpiInProj E{UX, XR, YR};
        pg8::gemm_phase<EpiInProj, pg8::StdOrder, true>(lds, g, S, E);
        SEAM(1);
    }

    if (IN(2)) {
        { pg8::Gemm g{UXW, 256, 256}; S5Order S{G, bx, (const char*)UX, (const char*)(args.ws + WS_BTA), (size_t)256 * 256 * 2}; EpiS5A E{V};
          pg8::gemm_phase<EpiS5A, S5Order, true>(lds, g, S, E); }
        { const int c8 = tid & 63; float cw[4][8], cb[8]; const float* CW = inp(pt, I_CW); const float* CB = inp(pt, I_CB);
#pragma unroll
          for (int e = 0; e < 8; ++e) { cb[e] = CB[c8 * 8 + e];
#pragma unroll
              for (int k = 0; k < 4; ++k) cw[k][e] = CW[k * WLRU + c8 * 8 + e]; }
          for (int id = bx * 512 + tid; id < T * 64; id += G * 512) { const int row = id >> 6, t = row & (SEQ - 1); float o[8];
#pragma unroll
              for (int e = 0; e < 8; ++e) o[e] = cb[e];
#pragma unroll
              for (int k = 0; k < 4; ++k) { if (t - 3 + k >= 0) { const u32x4 xw = *(const u32x4*)(XR + (size_t)(row - 3 + k) * WLRU + c8 * 8);
#pragma unroll
                  for (int e = 0; e < 8; ++e) { const unsigned w = xw[e >> 1]; o[e] += cw[k][e] * ((e & 1) ? bfhi(w) : bflo(w)); } } }
              u32x4 w; w.x = cvt_pk_bf16(o[0], o[1]); w.y = cvt_pk_bf16(o[2], o[3]); w.z = cvt_pk_bf16(o[4], o[5]); w.w = cvt_pk_bf16(o[6], o[7]);
              *(u32x4*)(XC + (size_t)row * WLRU + c8 * 8) = w; } }
        SEAM(2);
    }

    if (IN(3)) {
        if (tid < 128) {
            const f32x2* PW16 = (const f32x2*)(args.ws + WS_PW16);
            for (int id = bx * 128 + tid; id < NG * BATCH * NS; id += G * 128) { const int n = id & 63, b = (id >> 6) & 15, g = id >> 10; const f32x2 lam = PW16[g * NS + n];
                const f32x2* vp = (const f32x2*)(V + ((size_t)(g * 2048 + b * NCHUNK)) * 128 + 2 * n); unsigned* up = (unsigned*)(UX + ((size_t)((g * 16 + b) * NCHUNK)) * UXW + 256 + 2 * n);
                float sr = 0.f, si = 0.f;
#pragma unroll 8
                for (int c = 0; c < NCHUNK; ++c) { const f32x2 v = vp[(size_t)c * 64]; up[(size_t)c * (UXW / 2)] = cvt_pk_bf16(sr, si);
                    const float nr = lam.x * sr - lam.y * si + v.x, ni = lam.x * si + lam.y * sr + v.y; sr = nr; si = ni; } }
        }
        { pg8::Gemm g{WLRU, 256, 256}; GateOrder S{G, bx, (const char*)XC, (const char*)(args.ws + WS_WGATE4)};
          EpiGate E{XC, LG, inp(pt, I_BA), inp(pt, I_BX), (const float*)(args.ws + WS_LS8)};
          pg8::gemm_phase<EpiGate, GateOrder, true>(lds, g, S, E); }
        SEAM(3);
    }

    if (IN(4)) {
        { pg8::Gemm g{UXW, UXW, UXW}; S5Order S{G, bx, (const char*)UX, (const char*)(args.ws + WS_BTC), (size_t)256 * UXW * 2}; EpiS5C E{Z};
          pg8::gemm_phase<EpiS5C, S5Order, true>(lds, g, S, E); }
        { LAS float* segS = (LAS float*)lds; LAS float* segH = segS + 32 * 32;
          const int cp = tid & 15, seg = tid >> 4;
          for (int item = bx; item < BATCH * 16; item += G) { const int b = item >> 4, ch = (item & 15) * 32 + 2 * cp; const size_t row0 = (size_t)b * SEQ + seg * 64;
              const unsigned* lg = LG + row0 * WLRU + ch;
              float S0 = 0.f, S1 = 0.f, H0 = 0.f, H1 = 0.f;
#pragma unroll 8
              for (int k = 0; k < 64; ++k) { const u32x2 w = *(const u32x2*)(lg + (size_t)k * WLRU); const float l0 = bflo(w.x), g0 = bfhi(w.x), l1 = bflo(w.y), g1 = bfhi(w.y);
                  H0 = __expf(l0) * H0 + g0; H1 = __expf(l1) * H1 + g1; S0 += l0; S1 += l1; }
              segS[seg * 32 + 2 * cp] = S0; segS[seg * 32 + 2 * cp + 1] = S1; segH[seg * 32 + 2 * cp] = H0; segH[seg * 32 + 2 * cp + 1] = H1;
              __syncthreads();
              float h0 = 0.f, h1 = 0.f;
              for (int s = 0; s < seg; ++s) { h0 = __expf(segS[s * 32 + 2 * cp]) * h0 + segH[s * 32 + 2 * cp]; h1 = __expf(segS[s * 32 + 2 * cp + 1]) * h1 + segH[s * 32 + 2 * cp + 1]; }
              const bf16_t* yr = YR + row0 * WLRU + ch; bf16_t* mo = MIX + row0 * DM + WS5 + ch;
#pragma unroll 8
              for (int k = 0; k < 64; ++k) { const u32x2 w = *(const u32x2*)(lg + (size_t)k * WLRU); const unsigned yw = *(const unsigned*)(yr + (size_t)k * WLRU);
                  h0 = __expf(bflo(w.x)) * h0 + bfhi(w.x); h1 = __expf(bflo(w.y)) * h1 + bfhi(w.y);
                  *(unsigned*)(mo + (size_t)k * DM) = cvt_pk_bf16(h0 * gelu_tanh(bflo(yw)), h1 * gelu_tanh(bfhi(yw))); }
              __syncthreads(); } }
        SEAM(4);
    }

    if (IN(5)) {
        pg8::Gemm g{WS5, WS5, WS5}; pg8::StdOrder S; S.init(T, WS5, G, bx, Z, WS5, args.ws + WS_WGLU, WS5);
        EpiGlu E{Z, MIX, inp(pt, I_BGLU), SS5, SSL};
        pg8::gemm_phase<EpiGlu, pg8::StdOrder, true>(lds, g, S, E);
        SEAM(5);
    }

    if (IN(6)) {
        pg8::Gemm g{DM, DM, DM}; pg8::StdOrder S; S.init(T, DM, G, bx, MIX, DM, args.ws + WS_WOUT, DM);
        { Unit u; for (int i = 0; S.next(i, u); ++i) for (int r = tid; r < 256; r += 512) { const int row = u.pm * 256 + r; float a5 = 0.f, al = 0.f;
#pragma unroll
              for (int e = 0; e < 8; ++e) { a5 += SS5[(size_t)row * 8 + e]; al += SSL[(size_t)row * 8 + e]; }
              const float rs1 = 1.0f / sqrtf(a5 * (1.f / WS5) + EPS), rs2 = 1.0f / sqrtf(al * (1.f / WLRU) + EPS);
              tab[(i * 256 + r) * 2] = rs1 / rs2; tab[(i * 256 + r) * 2 + 1] = rs2; } }
        __syncthreads();
        EpiOut E{inp(pt, I_X), X1, X1B, SSX, tab};
        pg8::gemm_phase<EpiOut, pg8::StdOrder, true>(lds, g, S, E);
        SEAM(6);
    }

    if (IN(7)) {
        pg8::Gemm g{DM, DM, DM}; pg8::StdOrder S; S.init(T, 2 * DFF, G, bx, X1B, DM, args.ws + WS_WGU, DM);
        { Unit u; for (int i = 0; S.next(i, u); ++i) for (int r = tid; r < 256; r += 512) { const int row = u.pm * 256 + r; float s = 0.f;
#pragma unroll
              for (int e = 0; e < 16; ++e) s += SSX[(size_t)row * 16 + e];
              tab[i * 256 + r] = 1.0f / sqrtf(s * (1.f / DM) + EPS); } }
        __syncthreads();
        EpiGateUp E{ACT, tab};
        pg8::gemm_phase<EpiGateUp, pg8::StdOrder, true>(lds, g, S, E);
        SEAM(7);
    }

    if (IN(8)) {
        pg8::Gemm g{DFF, DFF, DFF}; pg8::StdOrder S; S.init(T, DM, G, bx, ACT, DFF, args.ws + WS_WD, DFF);
        EpiDown E{X1, args.out};
        pg8::gemm_phase<EpiDown, pg8::StdOrder, true>(lds, g, S, E);
        SEAM(8);
    }

    if (IN(9)) {
        int tid9 = threadIdx.x; asm volatile("" : "+v"(tid9)); const int lane = tid9 & 63;
        const int gw = vcu * 8 + wave, NGW = G * 8;
        const f32x4* gf = (const f32x4*)inp(pt, I_GF) + lane; f32x4 gv[4];
#pragma unroll
        for (int j = 0; j < 4; ++j) gv[j] = gf[64 * j];
        for (int m = gw; m < T; m += NGW) { f32x4* xr = (f32x4*)(args.out + (size_t)m * DM) + lane; f32x4 v[4]; float s = 0.f;
#pragma unroll
            for (int j = 0; j < 4; ++j) { v[j] = xr[64 * j]; s += (v[j].x * v[j].x + v[j].y * v[j].y) + (v[j].z * v[j].z + v[j].w * v[j].w); }
            const float rs = 1.0f / sqrtf(wave_sum(s) * (1.f / DM) + EPS);
#pragma unroll
            for (int j = 0; j < 4; ++j) xr[64 * j] = v[j] * rs * gv[j]; }
    }
#undef IN
#undef SEAM
#undef H
#undef UX
#undef XR
#undef YR
#undef XC
#undef V
#undef LG
#undef Z
#undef MIX
#undef X1
#undef X1B
#undef ACT
#undef SS5
#undef SSL
#undef SSX
#undef tab
}

extern "C" void kernel_launch(void* const* d_in, const int* in_sizes, int n_in, void* d_out, int out_size, void* d_ws, size_t ws_size, hipStream_t stream) {
    static int grid = 0;
    if (grid == 0) {
        if (n_in != 28 || in_sizes[0] != T * DM || out_size != T * DM || ws_size < WS_END) { fprintf(stderr, "kernel_launch: unexpected shapes (n_in %d, in0 %d, out %d, ws %zu); nothing launched\n", n_in, n_in > 0 ? in_sizes[0] : -1, out_size, ws_size); grid = -1; return; }
        int dev = 0, cus = 0, per_cu = 0;
        if (hipGetDevice(&dev) != hipSuccess || hipDeviceGetAttribute(&cus, hipDeviceAttributeMultiprocessorCount, dev) != hipSuccess) { grid = -1; return; }
        if (hipFuncSetAttribute((const void*)hybrid_fwd, hipFuncAttributeMaxDynamicSharedMemorySize, LDS_BYTES) != hipSuccess) { fprintf(stderr, "kernel_launch: hipFuncSetAttribute failed\n"); grid = -1; return; }
        if (hipOccupancyMaxActiveBlocksPerMultiprocessor(&per_cu, (const void*)hybrid_fwd, 512, LDS_BYTES) != hipSuccess || per_cu < 1) { fprintf(stderr, "kernel_launch: occupancy query reports %d workgroups per CU\n", per_cu); per_cu = 1; }
        (void)hipGetLastError();
        grid = cus;
        if (grid != 256) fprintf(stderr, "kernel_launch: %d CUs; the row-scale tables are sized for 256\n", grid);
    }
    if (grid < 0) return;
    if (hipMemsetAsync((char*)d_ws + WS_CTL, 0, CTL_ZERO_BYTES, stream) != hipSuccess) return;
    Args a{};
    for (int i = 0; i < 28; ++i) a.in[i] = (const float*)d_in[i];
    a.out = (float*)d_out; a.ws = (unsigned char*)d_ws;
    for (int li = 0; li < N_LAUNCHES; ++li) {
        if (N_LAUNCHES == 1) { a.ph_lo = 0; a.ph_hi = NPH; } else { a.ph_lo = li * NPH / N_LAUNCHES; a.ph_hi = (li + 1) * NPH / N_LAUNCHES; }
        a.li = li;
        hipLaunchKernelGGL(hybrid_fwd, dim3(grid), dim3(512), LDS_BYTES, stream, a);
        const hipError_t le = hipPeekAtLastError();
        if (le != hipSuccess) { fprintf(stderr, "kernel_launch: launch %d failed: %s\n", li, hipGetErrorName(le)); break; }
    }
}
```
